# Optimizing an MI355X kernel written in HIP

```python
import jax, jax.numpy as jnp
from jax import lax
import numpy as np

D_MODEL = 1024
BATCH = 8
SEQ = 2048
DEPTH = 1
DEC_BATCH = 128
DEC_SEQ = 4
PAST_LEN = 16384
PAGE_SIZE = 128

N_META = 16
POOL_WINDOWS = (2, 4, 8, 16)
N_POOL_GROUPS = len(POOL_WINDOWS)
POOL_W = D_MODEL // 2
POOL_GC = POOL_W // N_POOL_GROUPS
POOL_BUF = max(POOL_WINDOWS) - 1
CONV_W = D_MODEL - POOL_W
CONV_HEADS = 4
CONV_K = 3
CONV_BUF = CONV_K - 1
MIX_W = POOL_W + CONV_W
IN_W = POOL_W + 3 * CONV_W
D_FF = 4 * D_MODEL
EPS = 1e-6

kernel_name = "hymba_pool_shortconv_decode_step"


def rmsnorm(x, g):
    xf = x.astype(jnp.float32)
    y = xf * lax.rsqrt(jnp.mean(xf * xf, axis=-1, keepdims=True) + EPS)
    return (y * g.astype(jnp.float32)).astype(x.dtype)


def pool_mixer(u, u_past, p0, pool_w, pool_scale):
    b, t, _ = u.shape
    ext = jnp.concatenate([u_past, u], axis=1)
    cs = jnp.cumsum(ext.astype(jnp.float32), axis=1)
    cs = jnp.pad(cs, ((0, 0), (1, 0), (0, 0)))
    hi = cs[:, POOL_BUF + 1:]
    pos = p0 + jnp.arange(t, dtype=jnp.int32)
    means = []
    for g, w in enumerate(POOL_WINDOWS):
        sl = slice(g * POOL_GC, (g + 1) * POOL_GC)
        lo = cs[:, POOL_BUF + 1 - w: POOL_BUF + 1 - w + t, sl]
        cnt = jnp.minimum(w, pos + 1).astype(jnp.float32)
        means.append((hi[..., sl] - lo) / cnt[None, :, None])
    mean = jnp.concatenate(means, axis=-1)
    d = (mean - u.astype(jnp.float32)).astype(u.dtype).reshape(b, t, N_POOL_GROUPS, POOL_GC)
    out = jnp.einsum('btgc,gcd->btgd', d, pool_w).reshape(b, t, POOL_W)
    return out * pool_scale, ext[:, -POOL_BUF:]


def conv_mixer(bg, cg, h, z_past, conv_w):
    t = h.shape[1]
    z = cg * h
    ext = jnp.concatenate([z_past, z], axis=1)
    y = ext[:, 0:t] * conv_w[0] + ext[:, 1:1 + t] * conv_w[1] + ext[:, 2:2 + t] * conv_w[2]
    return bg * y, ext[:, -CONV_BUF:]


def layer(x, s_pool, s_conv, p0, norm1_g, w_in, pool_w, pool_scale, conv_w, w_out,
          norm2_g, w1, w2):
    hn = rmsnorm(x, norm1_g)
    proj = jnp.einsum('btd,de->bte', hn, w_in)
    u = proj[..., :POOL_W]
    bg = proj[..., POOL_W:POOL_W + CONV_W]
    cg = proj[..., POOL_W + CONV_W:POOL_W + 2 * CONV_W]
    hc = proj[..., POOL_W + 2 * CONV_W:]
    ya, new_pool = pool_mixer(u, s_pool, p0, pool_w, pool_scale)
    yb, new_conv = conv_mixer(bg, cg, hc, s_conv, conv_w)
    mix = jnp.concatenate([ya, yb], axis=-1)
    x = x + jnp.einsum('bte,ed->btd', mix, w_out)
    hn = rmsnorm(x, norm2_g)
    a = jax.nn.relu(jnp.einsum('btd,df->btf', hn, w1))
    x = x + jnp.einsum('btf,fd->btd', a * a, w2)
    return x, new_pool, new_conv


def setup_inputs(seed: int = 0) -> dict:
    key = jax.random.key(seed)
    ks = jax.random.split(key, 16)
    f32 = jnp.float32
    n = lambda k, s, sc: jax.random.normal(k, s, f32) * sc
    return {
        "x_prompt": n(ks[0], (BATCH, SEQ, D_MODEL), 1.0),
        "x_sample": n(ks[1], (DEC_BATCH, DEC_SEQ, D_MODEL), 1.0),
        "state_pool": n(ks[2], (DEPTH, DEC_BATCH, POOL_BUF, POOL_W), 1.0),
        "state_conv": n(ks[3], (DEPTH, DEC_BATCH, CONV_BUF, CONV_W), 1.0),
        "meta_tokens": n(ks[4], (N_META, D_MODEL), 1.0),
        "norm1_g": 1.0 + n(ks[5], (DEPTH, D_MODEL), 0.05),
        "w_in": n(ks[6], (DEPTH, D_MODEL, IN_W), D_MODEL ** -0.5),
        "pool_w": n(ks[7], (DEPTH, N_POOL_GROUPS, POOL_GC, POOL_GC), POOL_GC ** -0.5),
        "pool_scale": 1.0 + n(ks[8], (DEPTH, POOL_W), 0.1),
        "conv_w": n(ks[9], (DEPTH, CONV_K, CONV_W), CONV_K ** -0.5),
        "w_out": n(ks[10], (DEPTH, MIX_W, D_MODEL), MIX_W ** -0.5),
        "norm2_g": 1.0 + n(ks[11], (DEPTH, D_MODEL), 0.05),
        "w1": n(ks[12], (DEPTH, D_MODEL, D_FF), D_MODEL ** -0.5),
        "w2": n(ks[13], (DEPTH, D_FF, D_MODEL), D_FF ** -0.5),
        "final_g": 1.0 + n(ks[14], (D_MODEL,), 0.05),
    }


def reference(x_prompt, x_sample, state_pool, state_conv, meta_tokens, norm1_g, w_in,
              pool_w, pool_scale, conv_w, w_out, norm2_g, w1, w2, final_g):
    b = x_prompt.shape[0]
    meta = jnp.broadcast_to(meta_tokens.astype(x_prompt.dtype)[None], (b, N_META, D_MODEL))
    xp = jnp.concatenate([meta, x_prompt], axis=1)
    xs = x_sample
    zp_pool = jnp.zeros((b, POOL_BUF, POOL_W), x_prompt.dtype)
    zp_conv = jnp.zeros((b, CONV_BUF, CONV_W), x_prompt.dtype)
    pp, cp, ps, cs = [], [], [], []
    for l in range(DEPTH):
        params = (norm1_g[l], w_in[l], pool_w[l], pool_scale[l], conv_w[l], w_out[l],
                  norm2_g[l], w1[l], w2[l])
        xp, np_pool, np_conv = layer(xp, zp_pool, zp_conv, 0, *params)
        xs, ns_pool, ns_conv = layer(xs, state_pool[l], state_conv[l], PAST_LEN, *params)
        pp.append(np_pool); cp.append(np_conv); ps.append(ns_pool); cs.append(ns_conv)
    y_prompt = rmsnorm(xp, final_g)[:, N_META:]
    y_sample = rmsnorm(xs, final_g)
    new_pool_prompt = jnp.stack(pp, axis=0)
    new_conv_prompt = jnp.stack(cp, axis=0)
    new_pool_sample = jnp.stack(ps, axis=0)
    new_conv_sample = jnp.stack(cs, axis=0)
    return (y_prompt, y_sample, new_pool_prompt, new_conv_prompt, new_pool_sample, new_conv_sample)
```

```cpp
#include <hip/hip_runtime.h>
#include <hip/hip_cooperative_groups.h>
#include <cstdio>
#include <cstdint>
namespace pg8 {
#define PG8_LAS __attribute__((address_space(3)))
typedef unsigned short bf16_t;
typedef short bf16x8 __attribute__((ext_vector_type(8)));
typedef float f32x4 __attribute__((ext_vector_type(4)));
typedef unsigned u32x4 __attribute__((ext_vector_type(4)));
constexpr int BM = 256, BK = 64, HALF = 128, HTB = HALF * BK * 2  , STAGE_BYTES = 8 * HTB, NXCD = 8, WGM = 8;

__host__ __device__ __forceinline__ int lds_byte(int r, int c) { const int st = (r >> 4) * 2 + (c >> 5), rr = r & 15, cc = c & 31, ob = rr * 64 + cc * 2; return st * 1024 + (ob ^ (((ob >> 9) & 1) << 5)); }
__host__ __device__ __forceinline__ void stage_rc(int b, int& R, int& C) { const int st = b / 1024, sb = b % 1024, swz = sb ^ (((sb >> 9) & 1) << 5); R = (st >> 1) * 16 + swz / 64; C = (st & 1) * 32 + (swz % 64) / 2; }
__host__ __device__ __forceinline__ int perm32(int rho) { const int n = rho >> 4, i = rho & 15; return 8 * (i >> 2) + 4 * n + (i & 3); }

struct Unit { int pm, pn; };
struct Gemm { const bf16_t* A; const bf16_t* Bt; int M, N, K; };

struct StaticOrder {
    int nM, nN, nwg, G, c;
    __host__ __device__ void init(int M, int N, int G_, int c_) { nM = M / BM; nN = N / BM; nwg = nM * nN; G = G_; c = c_; }
    __host__ __device__ bool next(int i, Unit& u) const {
        const long L = (long)i * G + c; if (L >= nwg) return false;
        int wgid = (int)L; { const int q = nwg / NXCD, r = nwg % NXCD, xcd = wgid % NXCD, off = wgid / NXCD; wgid = (xcd < r ? xcd * (q + 1) : r * (q + 1) + (xcd - r) * q) + off; }
        const int nig = WGM * nN, gid = wgid / nig, fm = gid * WGM, gsz = (nM - fm) < WGM ? (nM - fm) : WGM;
        u.pm = fm + ((wgid % nig) % gsz); u.pn = (wgid % nig) / gsz; return true;
    }
    __device__ __forceinline__ void a_ready(const Unit&) const {}
    __device__ __forceinline__ void done(const Unit&) const {}
};

__device__ __forceinline__ unsigned cvt_pk_bf16(float lo, float hi) { unsigned r; asm volatile("v_cvt_pk_bf16_f32 %0, %1, %2" : "=v"(r) : "v"(lo), "v"(hi)); return r; }
typedef unsigned u32x2 __attribute__((ext_vector_type(2)));
constexpr float RMS_EPS = 1e-6f;
struct EpiProj {
    static constexpr bool PERM = true, AFTER_DRAIN = false;
    bf16_t *U, *BG, *Z;
    __device__ __forceinline__ void operator()(const f32x4 (&acc)[2][2][4][2], const Unit& u, int wr, int wc, int fr, int fq) const {
        const int row0 = u.pm * BM + wr * 64 + fr;
        if (u.pn < 4) {
            bf16_t* base = (u.pn < 2 ? U : BG) + (u.pn & 1) * 256 + wc * 32 + 8 * fq;
#pragma unroll
            for (int ai = 0; ai < 2; ++ai)
#pragma unroll
                for (int m = 0; m < 4; ++m) { bf16_t* rowp = base + (size_t)(row0 + ai * HALF + m * 16) * 512;
#pragma unroll
                    for (int bj = 0; bj < 2; ++bj) { const f32x4 v0 = acc[ai][bj][m][0], v1 = acc[ai][bj][m][1];
                        u32x4 w; w.x = cvt_pk_bf16(v0[0], v0[1]); w.y = cvt_pk_bf16(v0[2], v0[3]); w.z = cvt_pk_bf16(v1[0], v1[1]); w.w = cvt_pk_bf16(v1[2], v1[3]);
                        *(u32x4*)(rowp + bj * HALF) = w; } }
        } else {
            bf16_t* base = Z + (u.pn - 4) * 128 + wc * 32 + 8 * fq;
#pragma unroll
            for (int ai = 0; ai < 2; ++ai)
#pragma unroll
                for (int m = 0; m < 4; ++m) { bf16_t* rowp = base + (size_t)(row0 + ai * HALF + m * 16) * 512;
                    const f32x4 v0 = acc[ai][0][m][0] * acc[ai][1][m][0], v1 = acc[ai][0][m][1] * acc[ai][1][m][1];
                    u32x4 w; w.x = cvt_pk_bf16(v0[0], v0[1]); w.y = cvt_pk_bf16(v0[2], v0[3]); w.z = cvt_pk_bf16(v1[0], v1[1]); w.w = cvt_pk_bf16(v1[2], v1[3]);
                    *(u32x4*)rowp = w; }
        }
    }
};
struct EpiRes1 {
    static constexpr bool PERM = false, AFTER_DRAIN = false;
    const float* xp; const float* xs; float* X1; bf16_t* X1B; float* SS;
    __device__ __forceinline__ void operator()(const f32x4 (&acc)[2][2][4][2], const Unit& u, int wr, int wc, int fr, int fq) const {
        const int row0 = u.pm * BM + wr * 64 + fr, col0 = u.pn * BM + wc * 32 + 4 * fq;
#pragma unroll
        for (int ai = 0; ai < 2; ++ai)
#pragma unroll
            for (int m = 0; m < 4; ++m) { const int row = row0 + ai * HALF + m * 16;
                const float* res = (row < 16384 ? xp + (size_t)row * 1024 : xs + (size_t)(row - 16384) * 1024) + col0;
                float* o = X1 + (size_t)row * 1024 + col0; bf16_t* ob = X1B + (size_t)row * 1024 + col0; float ss = 0.f;
#pragma unroll
                for (int bj = 0; bj < 2; ++bj)
#pragma unroll
                    for (int n = 0; n < 2; ++n) { const int c = bj * HALF + n * 16; const f32x4 v = acc[ai][bj][m][n] + *(const f32x4*)(res + c);
                        *(f32x4*)(o + c) = v; u32x2 w; w.x = cvt_pk_bf16(v[0], v[1]); w.y = cvt_pk_bf16(v[2], v[3]); *(u32x2*)(ob + c) = w;
                        ss += (v[0] * v[0] + v[1] * v[1]) + (v[2] * v[2] + v[3] * v[3]); }
                ss += __shfl_xor(ss, 16); ss += __shfl_xor(ss, 32);
                if (fq == 0) SS[(size_t)row * 16 + u.pn * 4 + wc] = ss; }
    }
};
struct EpiFfn1 {
    static constexpr bool PERM = true, AFTER_DRAIN = false;
    bf16_t* H; const float* SS;
    __device__ __forceinline__ void operator()(const f32x4 (&acc)[2][2][4][2], const Unit& u, int wr, int wc, int fr, int fq) const {
        const int row0 = u.pm * BM + wr * 64 + fr, col0 = u.pn * BM + wc * 32 + 8 * fq;
#pragma unroll
        for (int ai = 0; ai < 2; ++ai)
#pragma unroll
            for (int m = 0; m < 4; ++m) { const int row = row0 + ai * HALF + m * 16;
                const f32x4* sp = (const f32x4*)(SS + (size_t)row * 16); const f32x4 a = (sp[0] + sp[1]) + (sp[2] + sp[3]);
                const float r = __builtin_amdgcn_rsqf(((a[0] + a[1]) + (a[2] + a[3])) * (1.0f / 1024.0f) + RMS_EPS);
                bf16_t* rowp = H + (size_t)row * 4096 + col0;
#pragma unroll
                for (int bj = 0; bj < 2; ++bj) { f32x4 v0 = acc[ai][bj][m][0] * r, v1 = acc[ai][bj][m][1] * r;
#pragma unroll
                    for (int j = 0; j < 4; ++j) { const float p = fmaxf(v0[j], 0.f), q = fmaxf(v1[j], 0.f); v0[j] = p * p; v1[j] = q * q; }
                    u32x4 w; w.x = cvt_pk_bf16(v0[0], v0[1]); w.y = cvt_pk_bf16(v0[2], v0[3]); w.z = cvt_pk_bf16(v1[0], v1[1]); w.w = cvt_pk_bf16(v1[2], v1[3]);
                    *(u32x4*)(rowp + bj * HALF) = w; } }
    }
};
struct EpiRes2 {
    static constexpr bool PERM = false, AFTER_DRAIN = false;
    float* X;
    __device__ __forceinline__ void operator()(const f32x4 (&acc)[2][2][4][2], const Unit& u, int wr, int wc, int fr, int fq) const {
        const int row0 = u.pm * BM + wr * 64 + fr, col0 = u.pn * BM + wc * 32 + 4 * fq;
#pragma unroll
        for (int ai = 0; ai < 2; ++ai)
#pragma unroll
            for (int m = 0; m < 4; ++m) { float* o = X + (size_t)(row0 + ai * HALF + m * 16) * 1024 + col0;
#pragma unroll
                for (int bj = 0; bj < 2; ++bj)
#pragma unroll
                    for (int n = 0; n < 2; ++n) { const int c = bj * HALF + n * 16; *(f32x4*)(o + c) = acc[ai][bj][m][n] + *(const f32x4*)(o + c); } }
    }
};
template <class Epi, class Sched, bool ALIGN_EPI = false, bool SP2 = false>
__device__ __forceinline__ void gemm_phase(PG8_LAS unsigned char* lds, const Gemm g, const Sched& S, const Epi& E) {
    const int tid = threadIdx.x, wid = __builtin_amdgcn_readfirstlane(tid >> 6), lane = tid & 63, wr = wid >> 2, wc = wid & 3, fr = lane & 15, fq = lane >> 4;
    const int K = g.K, nt = K / BK;
    unsigned voffA[2], voffB[2];
#pragma unroll
    for (int i = 0; i < 2; ++i) { int R, C; stage_rc(tid * 16 + i * 8192, R, C); const int Rb = Epi::PERM ? ((R & ~31) + perm32(R & 31)) : R;
        voffA[i] = (unsigned)(R * K + C) * 2u; voffB[i] = (unsigned)(Rb * K + C) * 2u; }
    const size_t kstep = (size_t)(BK * 2);
    const size_t hstep = (size_t)HALF * K * 2;
    const size_t tstep = 2 * hstep;
    const unsigned ldsw = (unsigned)wid * 1024u;
    const int aoff = lds_byte(wr * 64 + fr, fq * 8), boff = lds_byte(wc * 32 + fr, fq * 8);
#define PG8_SA(b, h) (((b) * 2 + (h)) * HTB)
#define PG8_SB(b, h) ((4 + (b) * 2 + (h)) * HTB)
#define PG8_STAGE(bufoff, gbase, voff) do { _Pragma("unroll") for (int _i = 0; _i < 2; ++_i) \
        __builtin_amdgcn_global_load_lds((const unsigned*)((const char*)(gbase) + (voff)[_i]), (PG8_LAS unsigned*)(lds + (bufoff) + ldsw + _i * 8192), 16, 0, 0); } while (0)
#define PG8_LDA(dst, b, h) do { _Pragma("unroll") for (int m = 0; m < 4; ++m) _Pragma("unroll") for (int k = 0; k < 2; ++k) dst[m][k] = *(const PG8_LAS bf16x8*)(lds + PG8_SA(b, h) + aoff + m * 2048 + k * 1024); } while (0)
#define PG8_LDB(dst, b, h) do { _Pragma("unroll") for (int n = 0; n < 2; ++n) _Pragma("unroll") for (int k = 0; k < 2; ++k) dst[n][k] = *(const PG8_LAS bf16x8*)(lds + PG8_SB(b, h) + boff + n * 2048 + k * 1024); } while (0)
#define PG8_MMA(ai, bj, At, Bt) do { __builtin_amdgcn_s_setprio(1); _Pragma("unroll") for (int m = 0; m < 4; ++m) _Pragma("unroll") for (int n = 0; n < 2; ++n) _Pragma("unroll") for (int k = 0; k < 2; ++k) \
        acc[ai][bj][m][n] = __builtin_amdgcn_mfma_f32_16x16x32_bf16(Bt[n][k], At[m][k], acc[ai][bj][m][n], 0, 0, 0); __builtin_amdgcn_s_setprio(0); } while (0)
#define PG8_WAIT_V(n) asm volatile("s_waitcnt vmcnt(" #n ")" ::: "memory")
#define PG8_WAIT_L(n) asm volatile("s_waitcnt lgkmcnt(" #n ")" ::: "memory")
#define PG8_BAR __builtin_amdgcn_s_barrier()
#define PG8_SCHED __builtin_amdgcn_sched_barrier(0)
    Unit cur, nxt; int ui = 0;
    if (!S.next(0, cur)) return;
    f32x4 acc[2][2][4][2];
#pragma unroll
    for (int a = 0; a < 2; ++a)
#pragma unroll
        for (int b = 0; b < 2; ++b)
#pragma unroll
            for (int m = 0; m < 4; ++m)
#pragma unroll
                for (int n = 0; n < 2; ++n) acc[a][b][m][n] = (f32x4){0.f, 0.f, 0.f, 0.f};
    bf16x8 At[4][2], B0[2][2], B1[2][2];
    const char* cA = (const char*)g.A + (size_t)cur.pm * tstep; const char* cB = (const char*)g.Bt + (size_t)cur.pn * tstep;
    S.a_ready(cur);
    if constexpr (SP2) {
        PG8_STAGE(PG8_SB(0, 0), cB, voffB); PG8_STAGE(PG8_SB(0, 1), cB + hstep, voffB); PG8_STAGE(PG8_SA(0, 0), cA, voffA); PG8_STAGE(PG8_SA(0, 1), cA + hstep, voffA);
        if (wr == 1) PG8_BAR;
        PG8_WAIT_V(2); PG8_BAR;
        PG8_STAGE(PG8_SB(1, 0), cB + kstep, voffB); PG8_STAGE(PG8_SA(1, 0), cA + kstep, voffA); PG8_STAGE(PG8_SB(1, 1), cB + hstep + kstep, voffB);
        PG8_WAIT_V(6); PG8_BAR;
    } else {
        PG8_STAGE(PG8_SB(0, 0), cB, voffB); PG8_STAGE(PG8_SA(0, 0), cA, voffA); PG8_STAGE(PG8_SB(0, 1), cB + hstep, voffB); PG8_STAGE(PG8_SA(0, 1), cA + hstep, voffA);
        if (wr == 1) PG8_BAR;
        PG8_WAIT_V(4); PG8_BAR;
        PG8_STAGE(PG8_SB(1, 0), cB + kstep, voffB); PG8_STAGE(PG8_SA(1, 0), cA + kstep, voffA); PG8_STAGE(PG8_SB(1, 1), cB + hstep + kstep, voffB);
        PG8_WAIT_V(6); PG8_BAR;
    }
    for (;;) {
        const bool has_next = S.next(ui + 1, nxt);
        const char* nA = has_next ? (const char*)g.A + (size_t)nxt.pm * tstep : cA; const char* nB = has_next ? (const char*)g.Bt + (size_t)nxt.pn * tstep : cB;
        for (int t = 0; t < nt; t += 2) {
            const bool last = (t == nt - 2);
            const char* a1 = cA + (size_t)(t + 1) * kstep;
            const char* a2 = last ? nA : cA + (size_t)(t + 2) * kstep; const char* b2 = last ? nB : cB + (size_t)(t + 2) * kstep;
            const char* a3 = a2 + kstep; const char* b3 = b2 + kstep;
            if (last && has_next) S.a_ready(nxt);
            if constexpr (SP2) {
            PG8_LDB(B0, 0, 0); PG8_LDB(B1, 0, 1); PG8_SCHED; PG8_LDA(At, 0, 0); PG8_STAGE(PG8_SA(1, 1), a1 + hstep, voffA);
            PG8_WAIT_V(8); PG8_WAIT_L(0); PG8_BAR; PG8_MMA(0, 0, At, B0); PG8_MMA(0, 1, At, B1); PG8_BAR; PG8_SCHED;
            PG8_LDA(At, 0, 1); PG8_STAGE(PG8_SB(0, 0), b2, voffB); PG8_STAGE(PG8_SB(0, 1), b2 + hstep, voffB); PG8_STAGE(PG8_SA(0, 0), a2, voffA);
            PG8_WAIT_V(8); PG8_WAIT_L(0); PG8_BAR; PG8_MMA(1, 0, At, B0); PG8_MMA(1, 1, At, B1); PG8_BAR; PG8_SCHED;
            PG8_LDB(B0, 1, 0); PG8_LDB(B1, 1, 1); PG8_SCHED; PG8_LDA(At, 1, 0); PG8_STAGE(PG8_SA(0, 1), a2 + hstep, voffA);
            PG8_WAIT_V(8); PG8_WAIT_L(0); PG8_BAR; PG8_MMA(0, 0, At, B0); PG8_MMA(0, 1, At, B1); PG8_BAR; PG8_SCHED;
            PG8_LDA(At, 1, 1); PG8_STAGE(PG8_SB(1, 0), b3, voffB); PG8_STAGE(PG8_SB(1, 1), b3 + hstep, voffB); PG8_STAGE(PG8_SA(1, 0), a3, voffA);
            PG8_WAIT_V(8); PG8_WAIT_L(0); PG8_BAR; PG8_MMA(1, 0, At, B0); PG8_MMA(1, 1, At, B1); PG8_BAR; PG8_SCHED;
            } else {
            PG8_LDB(B0, 0, 0); PG8_SCHED; PG8_LDA(At, 0, 0); PG8_STAGE(PG8_SA(1, 1), a1 + hstep, voffA);
            PG8_WAIT_L(8); PG8_BAR; PG8_WAIT_L(0); PG8_MMA(0, 0, At, B0); PG8_BAR; PG8_SCHED;
            PG8_LDB(B1, 0, 1); PG8_STAGE(PG8_SB(0, 0), b2, voffB);
            PG8_BAR; PG8_WAIT_L(0); PG8_MMA(0, 1, At, B1); PG8_BAR;
            PG8_LDA(At, 0, 1); PG8_STAGE(PG8_SA(0, 0), a2, voffA);
            PG8_BAR; PG8_WAIT_L(0); PG8_MMA(1, 0, At, B0); PG8_BAR; PG8_SCHED;
            PG8_STAGE(PG8_SB(0, 1), b2 + hstep, voffB);
            PG8_WAIT_V(6); PG8_BAR; PG8_MMA(1, 1, At, B1); PG8_BAR;
            PG8_LDB(B0, 1, 0); PG8_SCHED; PG8_LDA(At, 1, 0); PG8_STAGE(PG8_SA(0, 1), a2 + hstep, voffA);
            PG8_WAIT_L(8); PG8_BAR; PG8_WAIT_L(0); PG8_MMA(0, 0, At, B0); PG8_BAR; PG8_SCHED;
            PG8_LDB(B1, 1, 1); PG8_STAGE(PG8_SB(1, 0), b3, voffB);
            PG8_BAR; PG8_WAIT_L(0); PG8_MMA(0, 1, At, B1); PG8_BAR;
            PG8_LDA(At, 1, 1); PG8_STAGE(PG8_SA(1, 0), a3, voffA);
            PG8_BAR; PG8_WAIT_L(0); PG8_MMA(1, 0, At, B0); PG8_BAR; PG8_SCHED;
            PG8_STAGE(PG8_SB(1, 1), b3 + hstep, voffB);
            PG8_WAIT_V(6); PG8_BAR; PG8_MMA(1, 1, At, B1); PG8_BAR;
            }
        }
        if constexpr (ALIGN_EPI) { if (wr == 0) PG8_BAR; }
        if constexpr (!Epi::AFTER_DRAIN) { E(acc, cur, wr, wc, fr, fq); S.done(cur); }
        if (!has_next) break;
#pragma unroll
        for (int a = 0; a < 2; ++a)
#pragma unroll
            for (int b = 0; b < 2; ++b)
#pragma unroll
                for (int m = 0; m < 4; ++m)
#pragma unroll
                    for (int n = 0; n < 2; ++n) acc[a][b][m][n] = (f32x4){0.f, 0.f, 0.f, 0.f};
        cur = nxt; cA = nA; cB = nB; ++ui;
        if constexpr (ALIGN_EPI) { if (wr == 1) PG8_BAR; }
    }
    PG8_WAIT_V(0);
    if constexpr (!ALIGN_EPI) { if (wr == 0) PG8_BAR; }
    PG8_BAR;
    if constexpr (Epi::AFTER_DRAIN) { E.fused(acc, cur, wr, wc, fr, fq, lds, wid, lane); S.done(cur); }
#undef PG8_SA
#undef PG8_SB
#undef PG8_STAGE
#undef PG8_LDA
#undef PG8_LDB
#undef PG8_MMA
#undef PG8_WAIT_V
#undef PG8_WAIT_L
#undef PG8_BAR
#undef PG8_SCHED
}
}
constexpr int D = 1024, FF = 4096, INW = 2048, PWID = 512, NWAVES = 8;
constexpr int NPROMPT = 8 * 2048;
constexpr int NSAMP = 128 * 4;
constexpr int M2 = NPROMPT + NSAMP;
constexpr int MMETA = M2;
constexpr int M1 = M2 + 256;
constexpr float EPS = 1e-6f;
constexpr size_t OUT_PP = (size_t)M2 * D, OUT_CP = OUT_PP + 8 * 15 * 512, OUT_PS = OUT_CP + 8 * 2 * 512, OUT_CS = OUT_PS + 128 * 15 * 512, OUT_END = OUT_CS + 128 * 2 * 512;
constexpr size_t MiB = 1u << 20;
constexpr size_t WS_CTL = 0, CTL_ZERO_BYTES = 1 * MiB;
constexpr size_t WS_WIN = 2 * MiB, WS_WOUT = 6 * MiB, WS_W1 = 8 * MiB, WS_W2 = 16 * MiB, WS_PW = 24 * MiB, WS_SS = 25 * MiB;
constexpr size_t WS_XN = 28 * MiB, WS_U = 62 * MiB, WS_BG = 79 * MiB, WS_Z = 96 * MiB, WS_MIX = 113 * MiB;
constexpr size_t WS_H = 28 * MiB;
constexpr size_t WS_X1B = 160 * MiB, WS_END = 194 * MiB;
static_assert(WS_XN + (size_t)M1 * D * 2 <= WS_U && WS_U + (size_t)M1 * 512 * 2 <= WS_BG && WS_BG + (size_t)M1 * 512 * 2 <= WS_Z && WS_Z + (size_t)M1 * 512 * 2 <= WS_MIX && WS_MIX + (size_t)M2 * D * 2 <= WS_X1B, "ws map");
static_assert(WS_H + (size_t)M2 * FF * 2 <= WS_X1B && WS_X1B + (size_t)M2 * D * 2 <= WS_END && WS_SS + (size_t)M2 * 64 <= WS_XN, "ws map 2");
constexpr int CW_BAR = 4096;
constexpr int RING_OFF = 0, RING_BYTES = 131072;
constexpr int LDSCTL_OFF = RING_BYTES, MISC_OFF = LDSCTL_OFF + 320;
constexpr int LDS_BYTES = 147456;

#define GAS __attribute__((address_space(1)))
#define LAS __attribute__((address_space(3)))
typedef unsigned short bf16;
typedef unsigned v4u __attribute__((ext_vector_type(4)));
typedef float f32x4 __attribute__((ext_vector_type(4)));
typedef short bf16x8 __attribute__((ext_vector_type(8)));
typedef GAS unsigned gu32;
typedef GAS unsigned long long gu64;
#define RLX_AGENT __ATOMIC_RELAXED, __HIP_MEMORY_SCOPE_AGENT
#define LDS_WAIT() asm volatile("s_waitcnt lgkmcnt(0)" ::: "memory")
#define VM_WAIT() asm volatile("s_waitcnt vmcnt(0)" ::: "memory")
__device__ __forceinline__ unsigned long long rt() { return __builtin_amdgcn_s_memrealtime(); }
__device__ __forceinline__ unsigned f2bf(float f) { unsigned u = __builtin_bit_cast(unsigned, f); return (u + 0x7fffu + ((u >> 16) & 1u)) >> 16; }
__device__ __forceinline__ unsigned pk2(float lo, float hi) { return f2bf(lo) | (f2bf(hi) << 16); }

#define XB_TMO      128
#define XB_XCNT(j)  (256  + 64 * (j))
#define XB_XSUB(j)  (1280 + 64 * (j))
#define XB_XGEN(j)  (2304 + 64 * (j))
#define XB_TOP      3328
#define XB_TOPGEN   3392
#define XCD_BAR_WORDS 3456
#define XB_SPIN_CAP (1u << 18)

__device__ __forceinline__ unsigned xb_ld(unsigned* p)              { return __hip_atomic_load(p, __ATOMIC_RELAXED, __HIP_MEMORY_SCOPE_AGENT); }
__device__ __forceinline__ unsigned xb_add(unsigned* p, unsigned v) { return __hip_atomic_fetch_add(p, v, __ATOMIC_RELAXED, __HIP_MEMORY_SCOPE_AGENT); }
__device__ __forceinline__ unsigned xb_xcc_id() { return (unsigned)__builtin_amdgcn_s_getreg((3 << 11) | 20) & 0xFu; }
#define XB_SPIN(cond, bar) do { unsigned _sp = 0; while (cond) { __builtin_amdgcn_s_sleep(1); \
    if ((++_sp & 255u) == 0u) { if (xb_ld(&(bar)[XB_TMO])) break; if (_sp > XB_SPIN_CAP) { atomicAdd(&(bar)[XB_TMO], 1u); break; } } } } while (0)

struct XcdBarrier {
    unsigned* bar; unsigned x;
    volatile LAS unsigned* st;
};

__device__ __forceinline__ XcdBarrier xcd_barrier_post(unsigned* bar, volatile LAS unsigned* st) {
    XcdBarrier b; b.bar = bar; b.x = xb_xcc_id(); b.st = st;
    if (threadIdx.x == 0) (void)xb_add(&bar[XB_XCNT(b.x)], 1u);
    return b;
}
__device__ __forceinline__ void xcd_barrier_complete(unsigned* bar, unsigned x, unsigned& nloc, unsigned& nx) {
    const unsigned G = gridDim.x * gridDim.y * gridDim.z;
    unsigned sum, cnt, mine, sp = 0u;
    for (;;) {
        sum = 0u; cnt = 0u; mine = 0u;
#pragma unroll
        for (unsigned j = 0; j < 16; ++j) { const unsigned c = xb_ld(&bar[XB_XCNT(j)]); sum += c; cnt += (c > 0u) ? 1u : 0u; mine = (j == x) ? c : mine; }
        if (sum == G) break;
        __builtin_amdgcn_s_sleep(1);
        if ((++sp & 255u) == 0u) { if (xb_ld(&bar[XB_TMO])) break; if (sp > XB_SPIN_CAP) { atomicAdd(&bar[XB_TMO], 1u); break; } }
    }
    nloc = mine > 0u ? mine : 1u; nx = cnt > 0u ? cnt : 1u;
}

__device__ __forceinline__ void xcd_barrier(const XcdBarrier& b) {
    asm volatile("s_waitcnt vmcnt(0)" ::: "memory");
    __syncthreads();
    if (threadIdx.x == 0) {
        unsigned* bar = b.bar;
        __builtin_amdgcn_s_waitcnt(0);
        unsigned nloc = b.st[0], nx = b.st[1];
        if (nloc == 0u) { xcd_barrier_complete(bar, b.x, nloc, nx); b.st[0] = nloc; b.st[1] = nx; }
        const unsigned old = xb_add(&bar[XB_XSUB(b.x)], 1u);
        const unsigned gen = old / nloc;
        if (old + 1u == (gen + 1u) * nloc) {
            __builtin_amdgcn_fence(__ATOMIC_RELEASE, "agent");
            asm volatile("s_waitcnt vmcnt(0)" ::: "memory");
            const unsigned og = xb_add(&bar[XB_TOP], 1u);
            const unsigned tg = og / nx;
            if (og + 1u == (tg + 1u) * nx) xb_add(&bar[XB_TOPGEN], 1u);
            else XB_SPIN(xb_ld(&bar[XB_TOPGEN]) == tg, bar);
            __builtin_amdgcn_fence(__ATOMIC_ACQUIRE, "agent");
            xb_add(&bar[XB_XGEN(b.x)], 1u);
            asm volatile("s_waitcnt vmcnt(0)" ::: "memory");
        } else {
            XB_SPIN(xb_ld(&bar[XB_XGEN(b.x)]) == gen, bar);
            __builtin_amdgcn_fence(__ATOMIC_ACQUIRE, "agent");
            asm volatile("s_waitcnt vmcnt(0)" ::: "memory");
        }
    }
    __syncthreads();
}
__device__ __forceinline__ float wave_sum(float v) {
#pragma unroll
    for (int o = 1; o < 64; o <<= 1) v += __shfl_xor(v, o);
    return v;
}
struct Args { const float* in[15]; float* out; unsigned char* ws; int use_cg; int pad; };
enum { I_XP = 0, I_XS, I_SPOOL, I_SCONV, I_META, I_G1, I_WIN, I_POOLW, I_PSCALE, I_CONVW, I_WOUT, I_G2, I_W1, I_W2, I_FG };

__device__ __forceinline__ void p0_transpose_item(const float* W, int K, int N, bf16* WT, int k0, int n0, int orow0, const float* kscale, const float* nscale, LAS float* scr, int lane) {
    const float ns = nscale ? nscale[n0 + (lane & 31)] : 1.f;
#pragma unroll 8
    for (int i = 0; i < 32; ++i) { const int kk = 2 * i + (lane >> 5); const float ks = kscale ? kscale[k0 + kk] : 1.f; scr[kk * 33 + (lane & 31)] = W[(size_t)(k0 + kk) * N + n0 + (lane & 31)] * (ks * ns); }
    LDS_WAIT(); asm volatile("" ::: "memory");
    const int c = lane & 7;
#pragma unroll
    for (int j = 0; j < 4; ++j) { const int n = (lane >> 3) + 8 * j; const LAS float* s = scr + (8 * c) * 33 + n;
        v4u o; o.x = pk2(s[0 * 33], s[1 * 33]); o.y = pk2(s[2 * 33], s[3 * 33]); o.z = pk2(s[4 * 33], s[5 * 33]); o.w = pk2(s[6 * 33], s[7 * 33]);
        *(GAS v4u*)(WT + (size_t)(orow0 + n) * K + k0 + 8 * c) = o; }
    LDS_WAIT(); asm volatile("" ::: "memory");
}
__device__ __forceinline__ void rms_row_to_bf16(const float* xrow, const float* g, bf16* orow, int lane) {
    const GAS f32x4* xr = (const GAS f32x4*)xrow + lane; const GAS f32x4* gr = (const GAS f32x4*)g + lane;
    f32x4 v[4]; float s = 0.f;
#pragma unroll
    for (int j = 0; j < 4; ++j) { v[j] = xr[64 * j]; s += (v[j].x * v[j].x + v[j].y * v[j].y) + (v[j].z * v[j].z + v[j].w * v[j].w); }
    const float r = 1.f / sqrtf(wave_sum(s) * (1.f / D) + EPS);
    GAS unsigned long long* o8 = (GAS unsigned long long*)orow + lane;
#pragma unroll
    for (int j = 0; j < 4; ++j) { const f32x4 q = v[j] * r * gr[64 * j]; o8[64 * j] = (unsigned long long)pk2(q.x, q.y) | ((unsigned long long)pk2(q.z, q.w) << 32); }
}
__device__ __forceinline__ int win_row_of_col(int n0) {
    if (n0 < 1024) return n0;
    if (n0 < 1536) { const int c = n0 - 1024; return 1024 + (c >> 7) * 256 + (c & 127); }
    const int c = n0 - 1536; return 1024 + (c >> 7) * 256 + 128 + (c & 127);
}
__device__ __forceinline__ void p0_prologue(const Args& a, LAS unsigned char* lds, int vcu, int G, int wave, int lane) {
    unsigned char* ws = a.ws;
    LAS float* scr = (LAS float*)(lds + RING_OFF + wave * 16384);
    const int gw = vcu * NWAVES + wave, NGW = G * NWAVES;
    constexpr int I_IN = 16 * 64, I_OUT = 16 * 32, I_1 = 16 * 128, I_2 = 64 * 32, I_P = 4 * 8, NITEMS = I_IN + I_OUT + I_1 + I_2 + I_P;
    for (int it = gw; it < NITEMS; it += NGW) {
        int r = it;
        if (r < I_IN) { const int kb = r >> 6, nb = r & 63; p0_transpose_item(a.in[I_WIN], D, INW, (bf16*)(ws + WS_WIN), kb * 64, nb * 32, win_row_of_col(nb * 32), nullptr, nullptr, scr, lane); continue; } r -= I_IN;
        if (r < I_OUT) { const int kb = r >> 5, nb = r & 31; p0_transpose_item(a.in[I_WOUT], D, D, (bf16*)(ws + WS_WOUT), kb * 64, nb * 32, nb * 32, nullptr, nullptr, scr, lane); continue; } r -= I_OUT;
        if (r < I_1) { const int kb = r >> 7, nb = r & 127; p0_transpose_item(a.in[I_W1], D, FF, (bf16*)(ws + WS_W1), kb * 64, nb * 32, nb * 32, a.in[I_G2], nullptr, scr, lane); continue; } r -= I_1;
        if (r < I_2) { const int kb = r >> 5, nb = r & 31; p0_transpose_item(a.in[I_W2], FF, D, (bf16*)(ws + WS_W2), kb * 64, nb * 32, nb * 32, nullptr, nullptr, scr, lane); continue; } r -= I_2;
        { const int g = r >> 3, kb = (r >> 2) & 1, nb = r & 3; p0_transpose_item(a.in[I_POOLW] + g * 16384, 128, 128, (bf16*)(ws + WS_PW) + g * 16384, kb * 64, nb * 32, nb * 32, nullptr, a.in[I_PSCALE] + g * 128, scr, lane); }
    }
    bf16* XN = (bf16*)(ws + WS_XN);
    for (int m = gw; m < M1; m += NGW) {
        if (m < MMETA + 16) { const float* src = m < NPROMPT ? a.in[I_XP] + (size_t)m * D : (m < M2 ? a.in[I_XS] + (size_t)(m - NPROMPT) * D : a.in[I_META] + (size_t)(m - MMETA) * D);
            rms_row_to_bf16(src, a.in[I_G1], XN + (size_t)m * D, lane); }
        else { GAS v4u* o = (GAS v4u*)(XN + (size_t)m * D) + lane; o[0] = (v4u){0u, 0u, 0u, 0u}; o[64] = (v4u){0u, 0u, 0u, 0u}; }
    }
}
__device__ __forceinline__ void bf8_to_f32(const v4u v, float (&f)[8]) {
    f[0] = __builtin_bit_cast(float, v.x << 16); f[1] = __builtin_bit_cast(float, v.x & 0xffff0000u); f[2] = __builtin_bit_cast(float, v.y << 16); f[3] = __builtin_bit_cast(float, v.y & 0xffff0000u);
    f[4] = __builtin_bit_cast(float, v.z << 16); f[5] = __builtin_bit_cast(float, v.z & 0xffff0000u); f[6] = __builtin_bit_cast(float, v.w << 16); f[7] = __builtin_bit_cast(float, v.w & 0xffff0000u);
}
__device__ __forceinline__ v4u f32_to_bf8(const float (&f)[8]) { v4u o; o.x = pk2(f[0], f[1]); o.y = pk2(f[2], f[3]); o.z = pk2(f[4], f[5]); o.w = pk2(f[6], f[7]); return o; }
__device__ __forceinline__ void ld8f(const float* p, float (&f)[8]) { const f32x4 a = *(const GAS f32x4*)p, b = *(const GAS f32x4*)(p + 4); f[0] = a.x; f[1] = a.y; f[2] = a.z; f[3] = a.w; f[4] = b.x; f[5] = b.y; f[6] = b.z; f[7] = b.w; }

__device__ __forceinline__ void mixer_phase(const Args& a, LAS unsigned char* lds, int G, int tid, int wave, int lane) {
    unsigned char* ws = a.ws;
    const bf16* U = (const bf16*)(ws + WS_U); const bf16* BG = (const bf16*)(ws + WS_BG); const bf16* Z = (const bf16*)(ws + WS_Z); const bf16* PWt = (const bf16*)(ws + WS_PW); bf16* MIX = (bf16*)(ws + WS_MIX);
    const float* spool = a.in[I_SPOOL]; const float* sconv = a.in[I_SCONV]; const float* cw = a.in[I_CONVW];
    constexpr int UOFF = 0, DOFF = 81920, DP = 272;
    const int fr = lane & 15, fq = lane >> 4;
    for (int unit = blockIdx.x; unit < 264 * 4; unit += G) {
        const int rt = unit >> 2, g = unit & 3, w = 2 << g, m0 = rt * 64;
        const bool samp = rt >= 256;
        if (!samp) {
            const int b = rt >> 5, t0 = (rt & 31) * 64;
            for (int it = tid; it < 79 * 16; it += 512) { const int lr = it >> 4, c = it & 15, t = t0 - 15 + lr;
                const size_t srow = t >= 0 ? (size_t)(b * 2048 + t) : (size_t)(MMETA + 16 + t);
                *(LAS v4u*)(lds + UOFF + lr * 256 + c * 16) = *(const GAS v4u*)(U + srow * 512 + g * 128 + c * 8); }
        } else {
            const int st = rt - 256;
            for (int it = tid; it < 304 * 16; it += 512) { const int lr = it >> 4, c = it & 15, s = lr / 19, e = lr - s * 19, db = st * 16 + s;
                v4u v;
                if (e < 15) { float f[8]; ld8f(spool + ((size_t)(db * 15 + e)) * 512 + g * 128 + c * 8, f); v = f32_to_bf8(f); }
                else v = *(const GAS v4u*)(U + (size_t)(NPROMPT + db * 4 + e - 15) * 512 + g * 128 + c * 8);
                *(LAS v4u*)(lds + UOFF + lr * 256 + c * 16) = v; }
        }
        __syncthreads();
        const float inv = 1.0f / (float)w;
        for (int it = tid; it < 1024; it += 512) { const int r = it >> 4, c = it & 15; const int base = samp ? (r >> 2) * 19 + 15 + (r & 3) : r + 15;
            float s[8], uu[8], f[8];
            bf8_to_f32(*(const LAS v4u*)(lds + UOFF + base * 256 + c * 16), uu);
#pragma unroll
            for (int j = 0; j < 8; ++j) s[j] = uu[j];
            for (int k = 1; k < w; ++k) { bf8_to_f32(*(const LAS v4u*)(lds + UOFF + (base - k) * 256 + c * 16), f);
#pragma unroll
                for (int j = 0; j < 8; ++j) s[j] += f[j]; }
#pragma unroll
            for (int j = 0; j < 8; ++j) s[j] = s[j] * inv - uu[j];
            *(LAS v4u*)(lds + DOFF + r * DP + c * 16) = f32_to_bf8(s); }
        __syncthreads();
        {
            pg8::f32x4 acc[4];
#pragma unroll
            for (int rb = 0; rb < 4; ++rb) acc[rb] = (pg8::f32x4){0.f, 0.f, 0.f, 0.f};
#pragma unroll
            for (int kk = 0; kk < 4; ++kk) {
                const pg8::bf16x8 wf = *(const GAS pg8::bf16x8*)(PWt + (size_t)(g * 128 + wave * 16 + fr) * 128 + kk * 32 + fq * 8);
#pragma unroll
                for (int rb = 0; rb < 4; ++rb) { const pg8::bf16x8 df = *(const LAS pg8::bf16x8*)(lds + DOFF + (rb * 16 + fr) * DP + (kk * 32 + fq * 8) * 2);
                    acc[rb] = __builtin_amdgcn_mfma_f32_16x16x32_bf16(wf, df, acc[rb], 0, 0, 0); }
            }
#pragma unroll
            for (int rb = 0; rb < 4; ++rb) { pg8::u32x2 o; o.x = pk2(acc[rb][0], acc[rb][1]); o.y = pk2(acc[rb][2], acc[rb][3]);
                *(GAS pg8::u32x2*)(MIX + (size_t)(m0 + rb * 16 + fr) * 1024 + g * 128 + wave * 16 + fq * 4) = o; }
        }
        for (int it = tid; it < 1024; it += 512) { const int r = it >> 4, c = it & 15, m = m0 + r, ch = g * 128 + c * 8;
            float z0[8], z1[8], z2[8], bgv[8], c0[8], c1[8], c2[8], o[8];
            bf8_to_f32(*(const GAS v4u*)(Z + (size_t)m * 512 + ch), z0); bf8_to_f32(*(const GAS v4u*)(BG + (size_t)m * 512 + ch), bgv);
            if (!samp) { const int t = (rt & 31) * 64 + r;
                bf8_to_f32(*(const GAS v4u*)(Z + (size_t)(t >= 1 ? m - 1 : MMETA + 15) * 512 + ch), z1);
                bf8_to_f32(*(const GAS v4u*)(Z + (size_t)(t >= 2 ? m - 2 : MMETA + 14 + t) * 512 + ch), z2);
            } else { const int j = r & 3, db = (m - NPROMPT) >> 2;
                if (j >= 1) bf8_to_f32(*(const GAS v4u*)(Z + (size_t)(m - 1) * 512 + ch), z1); else ld8f(sconv + (size_t)(db * 2 + 1) * 512 + ch, z1);
                if (j >= 2) bf8_to_f32(*(const GAS v4u*)(Z + (size_t)(m - 2) * 512 + ch), z2); else ld8f(sconv + (size_t)(db * 2 + j) * 512 + ch, z2);
            }
            ld8f(cw + ch, c0); ld8f(cw + 512 + ch, c1); ld8f(cw + 1024 + ch, c2);
#pragma unroll
            for (int q = 0; q < 8; ++q) o[q] = bgv[q] * (c0[q] * z2[q] + c1[q] * z1[q] + c2[q] * z0[q]);
            *(GAS v4u*)(MIX + (size_t)m * 1024 + 512 + ch) = f32_to_bf8(o); }
        __syncthreads();
    }
    float* out = a.out;
    const size_t gt = (size_t)blockIdx.x * 512 + tid, GT = (size_t)G * 512;
    for (size_t i = gt; i < OUT_END - OUT_PP; i += GT) {
        float v;
        if (i < OUT_CP - OUT_PP) { const int ch = (int)(i & 511), q = (int)(i >> 9), b = q / 15, e = q - b * 15; v = __builtin_bit_cast(float, (unsigned)U[(size_t)(b * 2048 + 2033 + e) * 512 + ch] << 16); }
        else if (i < OUT_PS - OUT_PP) { const size_t k = i - (OUT_CP - OUT_PP); const int ch = (int)(k & 511), q = (int)(k >> 9), b = q >> 1, e = q & 1; v = __builtin_bit_cast(float, (unsigned)Z[(size_t)(b * 2048 + 2046 + e) * 512 + ch] << 16); }
        else if (i < OUT_CS - OUT_PP) { const size_t k = i - (OUT_PS - OUT_PP); const int ch = (int)(k & 511), q = (int)(k >> 9), db = q / 15, e = q - db * 15;
            v = e < 11 ? spool[(size_t)(db * 15 + e + 4) * 512 + ch] : __builtin_bit_cast(float, (unsigned)U[(size_t)(NPROMPT + db * 4 + e - 11) * 512 + ch] << 16); }
        else { const size_t k = i - (OUT_CS - OUT_PP); const int ch = (int)(k & 511), q = (int)(k >> 9), db = q >> 1, e = q & 1; v = __builtin_bit_cast(float, (unsigned)Z[(size_t)(NPROMPT + db * 4 + 2 + e) * 512 + ch] << 16); }
        out[OUT_PP + i] = v;
    }
}
__device__ __forceinline__ void final_norm_phase(const Args& a, int vcu, int G, int wave, int lane) {
    const int gw = vcu * NWAVES + wave, NGW = G * NWAVES;
    const GAS f32x4* gr = (const GAS f32x4*)a.in[I_FG] + lane;
    f32x4 gv[4];
#pragma unroll
    for (int j = 0; j < 4; ++j) gv[j] = gr[64 * j];
    for (int m = gw; m < M2; m += NGW) {
        GAS f32x4* xr = (GAS f32x4*)(a.out + (size_t)m * D) + lane;
        f32x4 v[4]; float s = 0.f;
#pragma unroll
        for (int j = 0; j < 4; ++j) { v[j] = xr[64 * j]; s += (v[j].x * v[j].x + v[j].y * v[j].y) + (v[j].z * v[j].z + v[j].w * v[j].w); }
        const float r = 1.f / sqrtf(wave_sum(s) * (1.f / D) + EPS);
#pragma unroll
        for (int j = 0; j < 4; ++j) xr[64 * j] = v[j] * r * gv[j];
    }
}

namespace cg = cooperative_groups;
__global__ void __launch_bounds__(NWAVES * 64, 2) fwd_megakernel(Args args) {
    extern __shared__ __attribute__((aligned(16))) unsigned char lds_raw[];
    LAS unsigned char* lds = (LAS unsigned char*)lds_raw;
    volatile LAS unsigned* MISC = (volatile LAS unsigned*)(lds + MISC_OFF);
    const int tid = threadIdx.x, lane = tid & 63, wave = __builtin_amdgcn_readfirstlane(tid >> 6);
    const int G = gridDim.x; const int bx = blockIdx.x; const int vcu = (G % 8 == 0) ? (bx % 8) * (G / 8) + bx / 8 : bx;
    unsigned char* ws = args.ws;
    for (int u = tid; u < (LDS_BYTES - LDSCTL_OFF) / 4; u += NWAVES * 64) ((LAS unsigned*)(lds + LDSCTL_OFF))[u] = 0u;
    __syncthreads();
    XcdBarrier bar = xcd_barrier_post((unsigned*)(ws + WS_CTL) + CW_BAR, MISC + 8);
    if (args.use_cg) cg::this_grid().sync();

    p0_prologue(args, lds, vcu, G, wave, lane);
    xcd_barrier(bar);
    { pg8::Gemm g{(const pg8::bf16_t*)(ws + WS_XN), (const pg8::bf16_t*)(ws + WS_WIN), M1, INW, D}; pg8::StaticOrder S; S.init(M1, INW, G, bx);
      pg8::EpiProj E{(pg8::bf16_t*)(ws + WS_U), (pg8::bf16_t*)(ws + WS_BG), (pg8::bf16_t*)(ws + WS_Z)};
      pg8::gemm_phase<pg8::EpiProj, pg8::StaticOrder, true, true>(lds + RING_OFF, g, S, E); }
    xcd_barrier(bar);
    mixer_phase(args, lds, G, tid, wave, lane);
    xcd_barrier(bar);
    { pg8::Gemm g{(const pg8::bf16_t*)(ws + WS_MIX), (const pg8::bf16_t*)(ws + WS_WOUT), M2, D, D}; pg8::StaticOrder S; S.init(M2, D, G, bx);
      pg8::EpiRes1 E{args.in[I_XP], args.in[I_XS], args.out, (pg8::bf16_t*)(ws + WS_X1B), (float*)(ws + WS_SS)};
      pg8::gemm_phase<pg8::EpiRes1, pg8::StaticOrder, true, true>(lds + RING_OFF, g, S, E); }
    xcd_barrier(bar);
    { pg8::Gemm g{(const pg8::bf16_t*)(ws + WS_X1B), (const pg8::bf16_t*)(ws + WS_W1), M2, FF, D}; pg8::StaticOrder S; S.init(M2, FF, G, bx);
      pg8::EpiFfn1 E{(pg8::bf16_t*)(ws + WS_H), (const float*)(ws + WS_SS)};
      pg8::gemm_phase<pg8::EpiFfn1, pg8::StaticOrder, true, true>(lds + RING_OFF, g, S, E); }
    xcd_barrier(bar);
    { pg8::Gemm g{(const pg8::bf16_t*)(ws + WS_H), (const pg8::bf16_t*)(ws + WS_W2), M2, D, FF}; pg8::StaticOrder S; S.init(M2, D, G, bx);
      pg8::EpiRes2 E{args.out};
      pg8::gemm_phase<pg8::EpiRes2, pg8::StaticOrder, true, true>(lds + RING_OFF, g, S, E); }
    xcd_barrier(bar);
    final_norm_phase(args, vcu, G, wave, lane);
}

extern "C" void kernel_launch(void* const* d_in, const int* in_sizes, int n_in, void* d_out, int out_size, void* d_ws, size_t ws_size, hipStream_t stream) {
    static int grid = 0;
    if (grid == 0) {
        if (n_in != 15 || (size_t)out_size != OUT_END || ws_size < WS_END) { fprintf(stderr, "kernel_launch: shape mismatch n_in %d out %d ws %zu\n", n_in, out_size, ws_size); grid = -1; return; }
        int dev = 0, cus = 0, per_cu = 0;
        if (hipGetDevice(&dev) != hipSuccess || hipDeviceGetAttribute(&cus, hipDeviceAttributeMultiprocessorCount, dev) != hipSuccess) { grid = -1; return; }
        if (hipFuncSetAttribute((const void*)fwd_megakernel, hipFuncAttributeMaxDynamicSharedMemorySize, LDS_BYTES) != hipSuccess) { fprintf(stderr, "kernel_launch: hipFuncSetAttribute failed\n"); grid = -1; return; }
        if (hipOccupancyMaxActiveBlocksPerMultiprocessor(&per_cu, (const void*)fwd_megakernel, NWAVES * 64, LDS_BYTES) != hipSuccess || per_cu < 1) { fprintf(stderr, "kernel_launch: occupancy query says %d\n", per_cu); per_cu = 1; }
        (void)hipGetLastError();
        grid = cus;
    }
    if (grid < 0) return;
    if (hipMemsetAsync((char*)d_ws + WS_CTL, 0, CTL_ZERO_BYTES, stream) != hipSuccess) { fprintf(stderr, "kernel_launch: memset failed\n"); return; }
    Args a{};
    for (int i = 0; i < 15; ++i) a.in[i] = (const float*)d_in[i];
    a.out = (float*)d_out; a.ws = (unsigned char*)d_ws; a.use_cg = 0; a.pad = 0;
    void* kargs[] = {&a};
    const hipError_t le = hipLaunchCooperativeKernel((const void*)fwd_megakernel, dim3(grid), dim3(NWAVES * 64), kargs, LDS_BYTES, stream);
    if (le != hipSuccess) fprintf(stderr, "kernel_launch: cooperative launch failed: %s (grid %d)\n", hipGetErrorName(le), grid);
}
```
